# Optimizing an MI355X kernel written in HIP

```python
import jax, jax.numpy as jnp
from jax import lax
import numpy as np

D_MODEL = 1024
BATCH = 8
SEQ = 8192
DEPTH = 1

N_META = 16
RET_HEADS = 8
RET_QK_DIM = 128
RET_V_DIM = 128
RET_CHUNK = 128
ROPE_BASE = 10000.0
LRU_WIDTH = D_MODEL
LRU_BLOCKS = 4
LRU_BLOCK = LRU_WIDTH // LRU_BLOCKS
CONV_WIDTH = 4
LRU_C = 8.0
FFN_HIDDEN = ((8 * D_MODEL // 3 + 255) // 256) * 256
RET_QK = RET_HEADS * RET_QK_DIM
RET_V = RET_HEADS * RET_V_DIM
IN_COLS = 2 * RET_QK + 2 * RET_V + 2 * LRU_WIDTH + 2 * D_MODEL
NORM_EPS = 1e-6

kernel_name = 'hybrid_retention_rglru_gated_block'


def rmsnorm(x, w):
    xf = x.astype(jnp.float32)
    y = xf * lax.rsqrt(jnp.mean(xf * xf, axis=-1, keepdims=True) + NORM_EPS)
    return (y * w.astype(jnp.float32)).astype(x.dtype)


def rotary(x, pos):
    d = x.shape[-1]
    inv_freq = ROPE_BASE ** (-jnp.arange(0, d, 2, dtype=jnp.float32) / d)
    ang = pos.astype(jnp.float32)[:, None] * inv_freq[None, :]
    cos = jnp.cos(ang)[None, :, None, :]
    sin = jnp.sin(ang)[None, :, None, :]
    x1, x2 = x[..., : d // 2], x[..., d // 2:]
    return jnp.concatenate([x1 * cos - x2 * sin, x2 * cos + x1 * sin], axis=-1)


def chunk_retention(q, k, v):
    B, T, H, dk = q.shape
    dv = v.shape[-1]
    C = RET_CHUNK
    pad = C - N_META
    padw = ((0, 0), (pad, 0), (0, 0), (0, 0))
    q, k, v = jnp.pad(q, padw), jnp.pad(k, padw), jnp.pad(v, padw)
    Tp = T + pad
    n_chunks = Tp // C
    log_g = jnp.log(1.0 - 2.0 ** (-5.0 - jnp.arange(H, dtype=jnp.float32)))
    idx = jnp.arange(C, dtype=jnp.float32)
    diff = idx[:, None] - idx[None, :]
    intra = jnp.where(diff[None] >= 0,
                      jnp.exp(jnp.maximum(diff, 0.0)[None] * log_g[:, None, None]), 0.0)
    q_decay = jnp.exp((idx + 1.0)[:, None] * log_g[None, :])
    k_decay = jnp.exp((C - 1.0 - idx)[:, None] * log_g[None, :])
    chunk_decay = jnp.exp(C * log_g)

    def to_chunks(a):
        return a.reshape(B, n_chunks, C, H, a.shape[-1]).transpose(1, 0, 2, 3, 4)

    def step(state, qkv):
        qc, kc, vc = qkv
        s = jnp.einsum('bchd,bmhd->bhcm', qc, kc) * intra[None]
        inner = jnp.einsum('bhcm,bmhe->bche', s, vc)
        cross = jnp.einsum('bchd,bhde->bche', qc, state) * q_decay[None, :, :, None]
        state = state * chunk_decay[None, :, None, None] + jnp.einsum(
            'bmhd,bmhe->bhde', kc * k_decay[None, :, :, None], vc)
        return state, inner + cross

    s0 = jnp.zeros((B, H, dk, dv), jnp.float32)
    _, ys = lax.scan(step, s0, (to_chunks(q), to_chunks(k), to_chunks(v)))
    out = ys.transpose(1, 0, 2, 3, 4).reshape(B, Tp, H, dv)
    return out[:, pad:]


def causal_depthwise_conv(x, w, b):
    T = x.shape[1]
    xp = jnp.pad(x, ((0, 0), (CONV_WIDTH - 1, 0), (0, 0)))
    y = b[None, None, :]
    for j in range(CONV_WIDTH):
        y = y + xp[:, j:j + T] * w[j][None, None, :]
    return y


def rg_lru(x, wa, ba, wx, bx, lam):
    B, T, W = x.shape
    xb = x.reshape(B, T, LRU_BLOCKS, LRU_BLOCK)
    r = jax.nn.sigmoid(jnp.einsum('btgi,gij->btgj', xb, wa).reshape(B, T, W) + ba)
    i = jax.nn.sigmoid(jnp.einsum('btgi,gij->btgj', xb, wx).reshape(B, T, W) + bx)
    log_a = -LRU_C * r * jax.nn.softplus(-lam)
    a = jnp.exp(log_a)
    u = jnp.sqrt(-jnp.expm1(2.0 * log_a)) * (i * x)

    def step(h, au):
        a_t, u_t = au
        h = a_t * h + u_t
        return h, h

    _, hs = lax.scan(step, jnp.zeros((B, W), jnp.float32),
                     (a.transpose(1, 0, 2), u.transpose(1, 0, 2)))
    return hs.transpose(1, 0, 2)


def setup_inputs(seed: int = 0) -> dict:
    key = jax.random.key(seed)
    ks = jax.random.split(key, 20)
    f32 = jnp.float32
    nrm = lambda k, s, sc: jax.random.normal(k, s, f32) * sc
    a0 = jax.random.uniform(ks[9], (DEPTH, LRU_WIDTH), f32, minval=0.9, maxval=0.999)
    a0r = a0 ** (1.0 / LRU_C)
    return {
        'x': nrm(ks[0], (BATCH, SEQ, D_MODEL), 1.0),
        'meta_tokens': nrm(ks[1], (N_META, D_MODEL), 1.0),
        'mix_norm_w': 1.0 + nrm(ks[2], (DEPTH, D_MODEL), 0.02),
        'w_in': nrm(ks[3], (DEPTH, D_MODEL, IN_COLS), D_MODEL ** -0.5),
        'conv_w': nrm(ks[4], (DEPTH, CONV_WIDTH, LRU_WIDTH), CONV_WIDTH ** -0.5),
        'conv_b': nrm(ks[5], (DEPTH, LRU_WIDTH), 0.01),
        'lru_wa': nrm(ks[6], (DEPTH, LRU_BLOCKS, LRU_BLOCK, LRU_BLOCK), LRU_BLOCK ** -0.5),
        'lru_ba': nrm(ks[7], (DEPTH, LRU_WIDTH), 0.01),
        'lru_wx': nrm(ks[8], (DEPTH, LRU_BLOCKS, LRU_BLOCK, LRU_BLOCK), LRU_BLOCK ** -0.5),
        'lru_bx': nrm(ks[10], (DEPTH, LRU_WIDTH), 0.01),
        'lru_lambda': jnp.log(a0r) - jnp.log1p(-a0r),
        'w_branch_ret': nrm(ks[11], (DEPTH, RET_V, D_MODEL), RET_V ** -0.5),
        'w_branch_lru': nrm(ks[12], (DEPTH, LRU_WIDTH, D_MODEL), LRU_WIDTH ** -0.5),
        'w_out': nrm(ks[13], (DEPTH, D_MODEL, D_MODEL), D_MODEL ** -0.5),
        'ffn_norm_w': 1.0 + nrm(ks[14], (DEPTH, D_MODEL), 0.02),
        'w_ffn_in': nrm(ks[15], (DEPTH, D_MODEL, 2 * FFN_HIDDEN), D_MODEL ** -0.5),
        'w_ffn_out': nrm(ks[16], (DEPTH, FFN_HIDDEN, D_MODEL), FFN_HIDDEN ** -0.5),
        'final_norm_w': 1.0 + nrm(ks[17], (D_MODEL,), 0.02),
    }


def reference(x, meta_tokens, mix_norm_w, w_in, conv_w, conv_b, lru_wa, lru_ba, lru_wx,
              lru_bx, lru_lambda, w_branch_ret, w_branch_lru, w_out, ffn_norm_w,
              w_ffn_in, w_ffn_out, final_norm_w):
    B = x.shape[0]
    f32 = jnp.float32
    meta = jnp.broadcast_to(meta_tokens.astype(x.dtype)[None], (B, N_META, D_MODEL))
    h = jnp.concatenate([meta, x], axis=1)
    T = h.shape[1]
    pos = jnp.arange(T)
    sizes = (RET_QK, RET_QK, RET_V, RET_V, LRU_WIDTH, LRU_WIDTH, D_MODEL, D_MODEL)
    split_at = [int(s) for s in np.cumsum(sizes)[:-1]]
    for l in range(DEPTH):
        u = rmsnorm(h, mix_norm_w[l])
        proj = u @ w_in[l]
        q, k, v, g_ret, lru_in, lru_gate, gate_a, gate_b = jnp.split(proj, split_at, axis=-1)
        q = rotary(q.reshape(B, T, RET_HEADS, RET_QK_DIM).astype(f32), pos)
        k = rotary(k.reshape(B, T, RET_HEADS, RET_QK_DIM).astype(f32), pos) * (RET_QK_DIM ** -0.5)
        v = v.reshape(B, T, RET_HEADS, RET_V_DIM).astype(f32)
        o = chunk_retention(q, k, v)
        o = o * lax.rsqrt(jnp.mean(o * o, axis=-1, keepdims=True) + NORM_EPS)
        o = o.reshape(B, T, RET_V).astype(h.dtype)
        y_ret = (jax.nn.silu(g_ret) * o) @ w_branch_ret[l]
        c = causal_depthwise_conv(lru_in.astype(f32), conv_w[l].astype(f32), conv_b[l].astype(f32))
        r = rg_lru(c, lru_wa[l].astype(f32), lru_ba[l].astype(f32), lru_wx[l].astype(f32),
                   lru_bx[l].astype(f32), lru_lambda[l].astype(f32)).astype(h.dtype)
        y_lru = (jax.nn.gelu(lru_gate) * r) @ w_branch_lru[l]
        mixed = jax.nn.sigmoid(gate_a) * y_ret + jax.nn.sigmoid(gate_b) * y_lru
        h = h + mixed @ w_out[l]
        u = rmsnorm(h, ffn_norm_w[l])
        gu = u @ w_ffn_in[l]
        g, up = gu[..., :FFN_HIDDEN], gu[..., FFN_HIDDEN:]
        h = h + (jax.nn.silu(g) * up) @ w_ffn_out[l]
    h = rmsnorm(h, final_norm_w)
    return h[:, N_META:]
```

```cpp
#include <hip/hip_runtime.h>
#include <hip/hip_cooperative_groups.h>
#include <cstdio>
namespace cg = cooperative_groups;

#define LAS __attribute__((address_space(3)))
typedef unsigned short bf16_t;
typedef short bf16x8 __attribute__((ext_vector_type(8)));
typedef short s16x4 __attribute__((ext_vector_type(4)));
typedef float f32x4 __attribute__((ext_vector_type(4)));
typedef unsigned u32x4 __attribute__((ext_vector_type(4)));
typedef unsigned u32x2 __attribute__((ext_vector_type(2)));

#ifndef MK_COOP
#define MK_COOP 1
#endif

constexpr int DM = 1024, NBATCH = 8, SEQ = 8192, NROW = NBATCH * SEQ, NMETA = 16, FH = 2816, INC = 8192;
constexpr float NORM_EPS = 1e-6f;
constexpr size_t MiB = 1u << 20;
constexpr size_t WS_Q = 0, WS_K = 128 * MiB, WS_V = 256 * MiB, WS_G = 384 * MiB, WS_LIN = 512 * MiB, WS_LG = 640 * MiB, WS_GA = 768 * MiB, WS_MISC = 896 * MiB;
constexpr size_t WS_W1T = WS_MISC, WS_WGT = WS_MISC + 16 * MiB, WS_WBR = WS_MISC + 17 * MiB, WS_WBL = WS_MISC + 19 * MiB, WS_WOUT = WS_MISC + 21 * MiB,
                 WS_WFI = WS_MISC + 23 * MiB, WS_WFO = WS_MISC + 34 * MiB, WS_COS = WS_MISC + 40 * MiB, WS_SIN = WS_MISC + 43 * MiB, WS_KVLM = WS_MISC + 46 * MiB,
                 WS_AUM = WS_MISC + 47 * MiB, WS_HMETA = WS_MISC + 48 * MiB, WS_AGGA = WS_MISC + 49 * MiB, WS_AGGH = WS_MISC + 53 * MiB, WS_HIN = WS_MISC + 57 * MiB,
                 WS_PART1 = WS_MISC + 61 * MiB, WS_PART2 = WS_MISC + 65 * MiB, WS_SPT = WS_HMETA + 8192;
constexpr size_t WS_HID = WS_Q, WS_H2B = WS_G, WS_KVST = WS_LIN;
constexpr int LDS_BYTES = 131072;

struct Params { const float* in[18]; float* out; unsigned char* ws; int ph_lo, ph_hi; };

typedef float f32x2_t __attribute__((ext_vector_type(2)));
typedef __bf16 bf16x2_t __attribute__((ext_vector_type(2)));
__device__ __forceinline__ unsigned cvt_pk_bf16(float lo, float hi) { const f32x2_t v = {lo, hi}; const bf16x2_t b = __builtin_convertvector(v, bf16x2_t); return __builtin_bit_cast(unsigned, b); }
__device__ __forceinline__ float bf_lo(unsigned w) { return __uint_as_float(w << 16); }
__device__ __forceinline__ float bf_hi(unsigned w) { return __uint_as_float(w & 0xffff0000u); }
__device__ __forceinline__ float bf2f(bf16_t b) { return __uint_as_float(((unsigned)b) << 16); }
__device__ __forceinline__ float fast_rcp(float x) { return __builtin_amdgcn_rcpf(x); }
__device__ __forceinline__ float sigmoidf_(float x) { return fast_rcp(1.0f + __expf(-x)); }
__device__ __forceinline__ float siluf_(float x) { return x * sigmoidf_(x); }
__device__ __forceinline__ float gelu_tanh_(float x) { const float z = 0.7978845608028654f * (x + 0.044715f * x * x * x); return x * sigmoidf_(2.0f * z); }
__device__ __forceinline__ void unpack8(const u32x4 w, float (&f)[8]) {
    f[0] = bf_lo(w.x); f[1] = bf_hi(w.x); f[2] = bf_lo(w.y); f[3] = bf_hi(w.y); f[4] = bf_lo(w.z); f[5] = bf_hi(w.z); f[6] = bf_lo(w.w); f[7] = bf_hi(w.w); }
__device__ __forceinline__ u32x4 pack8(const float (&f)[8]) { u32x4 w; w.x = cvt_pk_bf16(f[0], f[1]); w.y = cvt_pk_bf16(f[2], f[3]); w.z = cvt_pk_bf16(f[4], f[5]); w.w = cvt_pk_bf16(f[6], f[7]); return w; }
template <int S> __device__ __forceinline__ float dpp_shr(float v, float ident) {
    return __int_as_float(__builtin_amdgcn_update_dpp(__float_as_int(ident), __float_as_int(v), 0x110 + S, 0xf, 0xf, false)); }
__device__ __forceinline__ float neg_expm1_2x(float la, float a) {
    const float y = 2.0f * la;
    const float poly = -y * (1.0f + y * (0.5f + y * (0.16666667f + y * (0.041666668f + y * 0.008333334f))));
    return y > -0.25f ? poly : 1.0f - a * a;
}
__device__ __forceinline__ float head_log2g(int h) { return log2f(1.0f - exp2f(-5.0f - (float)h)); }

namespace pg8 {
constexpr int BM = 256, BK = 64, HALF = 128, HTB = HALF * BK * 2, STAGE_BYTES = 8 * HTB, NXCD = 8, WGM = 8;
__host__ __device__ __forceinline__ int lds_byte(int r, int c) { const int st = (r >> 4) * 2 + (c >> 5), rr = r & 15, cc = c & 31, ob = rr * 64 + cc * 2; return st * 1024 + (ob ^ (((ob >> 9) & 1) << 5)); }
__host__ __device__ __forceinline__ void stage_rc(int b, int& R, int& C) { const int st = b / 1024, sb = b % 1024, swz = sb ^ (((sb >> 9) & 1) << 5); R = (st >> 1) * 16 + swz / 64; C = (st & 1) * 32 + (swz % 64) / 2; }
__host__ __device__ __forceinline__ int perm32(int rho) { const int n = rho >> 4, i = rho & 15; return 8 * (i >> 2) + 4 * n + (i & 3); }

struct Unit { int pm, pn; };
struct Gemm { const bf16_t* A; const bf16_t* Bt; int M, N, K, lda, agrp; };

struct StaticOrder {
    int nM, nN, nwg, G, c;
    __device__ void init(int M, int N, int G_, int c_) { nM = M / BM; nN = N / BM; nwg = nM * nN; G = G_; c = c_; }
    __device__ bool next(int i, Unit& u) const {
        const long L = (long)i * G + c; if (L >= nwg) return false;
        int wgid = (int)L; { const int q = nwg / NXCD, r = nwg % NXCD, xcd = wgid % NXCD, off = wgid / NXCD; wgid = (xcd < r ? xcd * (q + 1) : r * (q + 1) + (xcd - r) * q) + off; }
        const int nig = WGM * nN, gid = wgid / nig, fm = gid * WGM, gsz = (nM - fm) < WGM ? (nM - fm) : WGM;
        u.pm = fm + ((wgid % nig) % gsz); u.pn = (wgid % nig) / gsz; return true;
    }
};

template <class Epi, bool APERM>
__device__ __forceinline__ void gemm_phase(LAS unsigned char* lds, const Gemm g, const StaticOrder& S, const Epi& E) {
    const int tid = threadIdx.x, wid = __builtin_amdgcn_readfirstlane(tid >> 6), lane = tid & 63, wr = wid >> 2, wc = wid & 3, fr = lane & 15, fq = lane >> 4;
    const int K = g.K, nt = K / BK;
    unsigned voffA[2], voffB[2];
#pragma unroll
    for (int i = 0; i < 2; ++i) { int R, C; stage_rc(tid * 16 + i * 8192, R, C); const int Ra = APERM ? ((R & 64) + 4 * (R & 15) + ((R >> 4) & 3)) : R;
        voffA[i] = (unsigned)(Ra * g.lda + C) * 2u; voffB[i] = (unsigned)(R * K + C) * 2u; }
    const size_t kstep = (size_t)(BK * 2);
    const size_t hstepA = (size_t)HALF * g.lda * 2, hstepB = (size_t)HALF * K * 2;
    const size_t tstepA = 2 * hstepA, tstepB = 2 * hstepB;
    const unsigned ldsw = (unsigned)wid * 1024u;
    const int aoff = lds_byte(wr * 64 + fr, fq * 8), boff = lds_byte(wc * 32 + fr, fq * 8);
#define PG8_SA(b, h) (((b) * 2 + (h)) * HTB)
#define PG8_SB(b, h) ((4 + (b) * 2 + (h)) * HTB)
#define PG8_STAGE(bufoff, gbase, voff) do { _Pragma("unroll") for (int _i = 0; _i < 2; ++_i) \
        __builtin_amdgcn_global_load_lds((const unsigned*)((const char*)(gbase) + (voff)[_i]), (LAS unsigned*)(lds + (bufoff) + ldsw + _i * 8192), 16, 0, 0); } while (0)
#define PG8_LDA(dst, b, h) do { _Pragma("unroll") for (int m = 0; m < 4; ++m) _Pragma("unroll") for (int k = 0; k < 2; ++k) dst[m][k] = *(const LAS bf16x8*)(lds + PG8_SA(b, h) + aoff + m * 2048 + k * 1024); } while (0)
#define PG8_LDB(dst, b, h) do { _Pragma("unroll") for (int n = 0; n < 2; ++n) _Pragma("unroll") for (int k = 0; k < 2; ++k) dst[n][k] = *(const LAS bf16x8*)(lds + PG8_SB(b, h) + boff + n * 2048 + k * 1024); } while (0)
#define PG8_MMA(ai, bj, At, Bt) do { __builtin_amdgcn_s_setprio(1); _Pragma("unroll") for (int m = 0; m < 4; ++m) _Pragma("unroll") for (int n = 0; n < 2; ++n) _Pragma("unroll") for (int k = 0; k < 2; ++k) \
        acc[ai][bj][m][n] = __builtin_amdgcn_mfma_f32_16x16x32_bf16(Bt[n][k], At[m][k], acc[ai][bj][m][n], 0, 0, 0); __builtin_amdgcn_s_setprio(0); } while (0)
#define PG8_WAIT_V(n) asm volatile("s_waitcnt vmcnt(" #n ")" ::: "memory")
#define PG8_WAIT_L(n) asm volatile("s_waitcnt lgkmcnt(" #n ")" ::: "memory")
#define PG8_BAR __builtin_amdgcn_s_barrier()
#define PG8_SCHED __builtin_amdgcn_sched_barrier(0)
    Unit cur, nxt; int ui = 0;
    if (!S.next(0, cur)) return;
    f32x4 acc[2][2][4][2];
#pragma unroll
    for (int a = 0; a < 2; ++a)
#pragma unroll
        for (int b = 0; b < 2; ++b)
#pragma unroll
            for (int m = 0; m < 4; ++m)
#pragma unroll
                for (int n = 0; n < 2; ++n) acc[a][b][m][n] = (f32x4){0.f, 0.f, 0.f, 0.f};
    bf16x8 At[4][2], B0[2][2], B1[2][2];
    const char* cA = (const char*)g.A + (size_t)cur.pm * tstepA + (g.agrp ? (size_t)(cur.pn >> 1) * 512 : 0); const char* cB = (const char*)g.Bt + (size_t)cur.pn * tstepB;
    PG8_STAGE(PG8_SB(0, 0), cB, voffB); PG8_STAGE(PG8_SA(0, 0), cA, voffA); PG8_STAGE(PG8_SB(0, 1), cB + hstepB, voffB); PG8_STAGE(PG8_SA(0, 1), cA + hstepA, voffA);
    if (wr == 1) PG8_BAR;
    PG8_WAIT_V(4); PG8_BAR;
    PG8_STAGE(PG8_SB(1, 0), cB + kstep, voffB); PG8_STAGE(PG8_SA(1, 0), cA + kstep, voffA); PG8_STAGE(PG8_SB(1, 1), cB + hstepB + kstep, voffB);
    PG8_WAIT_V(6); PG8_BAR;
    for (;;) {
        const bool has_next = S.next(ui + 1, nxt);
        const char* nA = has_next ? (const char*)g.A + (size_t)nxt.pm * tstepA + (g.agrp ? (size_t)(nxt.pn >> 1) * 512 : 0) : cA; const char* nB = has_next ? (const char*)g.Bt + (size_t)nxt.pn * tstepB : cB;
        for (int t = 0; t < nt; t += 2) {
            const bool last = (t == nt - 2);
            const char* a1 = cA + (size_t)(t + 1) * kstep;
            const char* a2 = last ? nA : cA + (size_t)(t + 2) * kstep; const char* b2 = last ? nB : cB + (size_t)(t + 2) * kstep;
            const char* a3 = a2 + kstep; const char* b3 = b2 + kstep;
            PG8_LDB(B0, 0, 0); PG8_SCHED; PG8_LDA(At, 0, 0); PG8_STAGE(PG8_SA(1, 1), a1 + hstepA, voffA);
            PG8_WAIT_L(8); PG8_BAR; PG8_WAIT_L(0); PG8_MMA(0, 0, At, B0); PG8_BAR; PG8_SCHED;
            PG8_LDB(B1, 0, 1); PG8_STAGE(PG8_SB(0, 0), b2, voffB);
            PG8_BAR; PG8_WAIT_L(0); PG8_MMA(0, 1, At, B1); PG8_BAR;
            PG8_LDA(At, 0, 1); PG8_STAGE(PG8_SA(0, 0), a2, voffA);
            PG8_BAR; PG8_WAIT_L(0); PG8_MMA(1, 0, At, B0); PG8_BAR; PG8_SCHED;
            PG8_STAGE(PG8_SB(0, 1), b2 + hstepB, voffB);
            PG8_WAIT_V(6); PG8_BAR; PG8_MMA(1, 1, At, B1); PG8_BAR;
            PG8_LDB(B0, 1, 0); PG8_SCHED; PG8_LDA(At, 1, 0); PG8_STAGE(PG8_SA(0, 1), a2 + hstepA, voffA);
            PG8_WAIT_L(8); PG8_BAR; PG8_WAIT_L(0); PG8_MMA(0, 0, At, B0); PG8_BAR; PG8_SCHED;
            PG8_LDB(B1, 1, 1); PG8_STAGE(PG8_SB(1, 0), b3, voffB);
            PG8_BAR; PG8_WAIT_L(0); PG8_MMA(0, 1, At, B1); PG8_BAR;
            PG8_LDA(At, 1, 1); PG8_STAGE(PG8_SA(1, 0), a3, voffA);
            PG8_BAR; PG8_WAIT_L(0); PG8_MMA(1, 0, At, B0); PG8_BAR; PG8_SCHED;
            PG8_STAGE(PG8_SB(1, 1), b3 + hstepB, voffB);
            PG8_WAIT_V(6); PG8_BAR; PG8_MMA(1, 1, At, B1); PG8_BAR;
        }
        E(acc, cur, wr, wc, fr, fq);
        if (!has_next) break;
#pragma unroll
        for (int a = 0; a < 2; ++a)
#pragma unroll
            for (int b = 0; b < 2; ++b)
#pragma unroll
                for (int m = 0; m < 4; ++m)
#pragma unroll
                    for (int n = 0; n < 2; ++n) acc[a][b][m][n] = (f32x4){0.f, 0.f, 0.f, 0.f};
        cur = nxt; cA = nA; cB = nB; ++ui;
    }
    PG8_WAIT_V(0);
    if (wr == 0) PG8_BAR;
    PG8_BAR;
#undef PG8_SA
#undef PG8_SB
#undef PG8_STAGE
#undef PG8_LDA
#undef PG8_LDB
#undef PG8_MMA
#undef PG8_WAIT_V
#undef PG8_WAIT_L
#undef PG8_BAR
#undef PG8_SCHED
}
}
using pg8::Unit;
typedef f32x4 AccT[2][2][4][2];

struct Epi1 {
    unsigned char* ws; unsigned char* outb; const float* cosT; const float* sinT;
    __device__ __forceinline__ void operator()(const AccT& acc, const Unit& u, int wr, int wc, int fr, int fq) const {
        const int type = u.pn >> 2, colt = (u.pn & 3) * 256;
        const int row0 = u.pm * 256 + wr * 64 + fr;
        if (type < 2) {
            bf16_t* dst = (bf16_t*)(ws + (type == 0 ? WS_Q : WS_K));
            const float sc = type == 0 ? 1.0f : 0.08838834764831845f;
            const int i0 = 16 * wc + 4 * fq;
#pragma unroll
            for (int ai = 0; ai < 2; ++ai)
#pragma unroll
                for (int m = 0; m < 4; ++m) {
                    const int row = row0 + ai * 128 + m * 16, pos = NMETA + (row & (SEQ - 1));
                    const f32x4 c4 = *(const f32x4*)(cosT + pos * 64 + i0) * sc, s4 = *(const f32x4*)(sinT + pos * 64 + i0) * sc;
#pragma unroll
                    for (int bj = 0; bj < 2; ++bj) {
                        const f32x4 x1 = acc[ai][bj][m][0], x2 = acc[ai][bj][m][1];
                        const f32x4 o1 = x1 * c4 - x2 * s4, o2 = x2 * c4 + x1 * s4;
                        bf16_t* d = dst + (size_t)row * DM + colt + bj * 128 + i0;
                        u32x2 w1, w2; w1.x = cvt_pk_bf16(o1[0], o1[1]); w1.y = cvt_pk_bf16(o1[2], o1[3]); w2.x = cvt_pk_bf16(o2[0], o2[1]); w2.y = cvt_pk_bf16(o2[2], o2[3]);
                        *(u32x2*)d = w1; *(u32x2*)(d + 64) = w2;
                    }
                }
        } else {
            bf16_t* dst;
            switch (type) { case 2: dst = (bf16_t*)(ws + WS_V); break; case 3: dst = (bf16_t*)(ws + WS_G); break; case 4: dst = (bf16_t*)(ws + WS_LIN); break;
                            case 5: dst = (bf16_t*)(ws + WS_LG); break; case 6: dst = (bf16_t*)(ws + WS_GA); break; default: dst = (bf16_t*)(outb + 128 * MiB); break; }
            const int col0 = colt + 32 * wc + 8 * fq;
#pragma unroll
            for (int ai = 0; ai < 2; ++ai)
#pragma unroll
                for (int m = 0; m < 4; ++m) {
                    const int row = row0 + ai * 128 + m * 16;
#pragma unroll
                    for (int bj = 0; bj < 2; ++bj) {
                        float v[8];
#pragma unroll
                        for (int j = 0; j < 4; ++j) { v[j] = acc[ai][bj][m][0][j]; v[4 + j] = acc[ai][bj][m][1][j]; }
                        if (type == 3) {
#pragma unroll
                            for (int j = 0; j < 8; ++j) v[j] = siluf_(v[j]);
                        } else if (type == 5) {
#pragma unroll
                            for (int j = 0; j < 8; ++j) v[j] = gelu_tanh_(v[j]);
                        } else if (type >= 6) {
#pragma unroll
                            for (int j = 0; j < 8; ++j) v[j] = sigmoidf_(v[j]);
                        }
                        *(u32x4*)(dst + (size_t)row * DM + col0 + bj * 128) = pack8(v);
                    }
                }
        }
    }
};

template <int PASS> struct EpiGate {
    unsigned char* ws; const bf16_t* C; const float* ba; const float* bx;
    __device__ __forceinline__ void operator()(const AccT& acc, const Unit& u, int wr, int wc, int fr, int fq) const {
        const int chan0 = 128 * u.pn + 32 * wc + 8 * fq;
        float* aggA = (float*)(ws + WS_AGGA); float* aggH = (float*)(ws + WS_AGGH); const float* hin = (const float*)(ws + WS_HIN); const float* spt = (const float*)(ws + WS_SPT);
        bf16_t* LG = (bf16_t*)(ws + WS_LG);
#pragma unroll
        for (int ai = 0; ai < 2; ++ai) {
            const int tok0 = u.pm * 256 + ai * 128 + wr * 64 + 4 * fr;
            const int seg = u.pm * 4 + ai * 2 + wr;
#pragma unroll
            for (int n = 0; n < 2; ++n) {
                const int ch4 = chan0 + 4 * n;
                u32x2 xw[4];
#pragma unroll
                for (int m = 0; m < 4; ++m) xw[m] = *(const u32x2*)(C + (size_t)(tok0 + m) * DM + ch4);
                float prev[4];
#pragma unroll
                for (int j = 0; j < 4; ++j) {
                    float al[4], hl[4]; float A = 1.0f, H = 0.0f;
                    const float sba = ba[ch4 + j], sbx = bx[ch4 + j], ssp = spt[ch4 + j];
#pragma unroll
                    for (int m = 0; m < 4; ++m) {
                        const unsigned w = j < 2 ? xw[m].x : xw[m].y;
                        const float x = (j & 1) ? bf_hi(w) : bf_lo(w);
                        const float r = sigmoidf_(acc[ai][0][m][n][j] + sba), ig = sigmoidf_(acc[ai][1][m][n][j] + sbx);
                        const float la = ssp * r;
                        const float a = __expf(la);
                        const float mult = __builtin_amdgcn_sqrtf(neg_expm1_2x(la, a));
                        const float uu = mult * ig * x;
                        H = a * H + uu; A = A * a; al[m] = A; hl[m] = H;
                    }
                    float As = A, Hs = H, ap, hp;
                    ap = dpp_shr<1>(As, 1.0f); hp = dpp_shr<1>(Hs, 0.0f); Hs = As * hp + Hs; As = As * ap;
                    ap = dpp_shr<2>(As, 1.0f); hp = dpp_shr<2>(Hs, 0.0f); Hs = As * hp + Hs; As = As * ap;
                    ap = dpp_shr<4>(As, 1.0f); hp = dpp_shr<4>(Hs, 0.0f); Hs = As * hp + Hs; As = As * ap;
                    ap = dpp_shr<8>(As, 1.0f); hp = dpp_shr<8>(Hs, 0.0f); Hs = As * hp + Hs; As = As * ap;
                    if (PASS == 1) { if (fr == 15) { aggA[(size_t)seg * DM + ch4 + j] = As; aggH[(size_t)seg * DM + ch4 + j] = Hs; } }
                    else {
                        const float Ae = dpp_shr<1>(As, 1.0f), He = dpp_shr<1>(Hs, 0.0f);
                        const float hc = He + Ae * hin[(size_t)seg * DM + ch4 + j];
                        if ((j & 1) == 0) {
#pragma unroll
                            for (int m = 0; m < 4; ++m) prev[m] = hl[m] + al[m] * hc;
                        } else {
#pragma unroll
                            for (int m = 0; m < 4; ++m) {
                                unsigned* pg = (unsigned*)(LG + (size_t)(tok0 + m) * DM + ch4 + j - 1);
                                const unsigned gw = *pg;
                                *pg = cvt_pk_bf16(bf_lo(gw) * prev[m], bf_hi(gw) * (hl[m] + al[m] * hc));
                            }
                        }
                    }
                    __builtin_amdgcn_sched_barrier(0);
                }
                __builtin_amdgcn_sched_barrier(0);
            }
        }
    }
};

template <int MODE> struct EpiBr {
    bf16_t* T; const bf16_t* GB;
    __device__ __forceinline__ void operator()(const AccT& acc, const Unit& u, int wr, int wc, int fr, int fq) const {
        const int row0 = u.pm * 256 + wr * 64 + fr, col0 = u.pn * 256 + 32 * wc + 8 * fq;
#pragma unroll
        for (int ai = 0; ai < 2; ++ai)
#pragma unroll
            for (int m = 0; m < 4; ++m) {
                const int row = row0 + ai * 128 + m * 16;
#pragma unroll
                for (int bj = 0; bj < 2; ++bj) {
                    bf16_t* pt = T + (size_t)row * DM + col0 + bj * 128;
                    float tv[8]; unpack8(*(const u32x4*)pt, tv);
                    float o[8];
                    if (MODE == 0) {
#pragma unroll
                        for (int j = 0; j < 4; ++j) { o[j] = tv[j] * acc[ai][bj][m][0][j]; o[4 + j] = tv[4 + j] * acc[ai][bj][m][1][j]; }
                    } else {
                        float gv[8]; unpack8(*(const u32x4*)(GB + (size_t)row * DM + col0 + bj * 128), gv);
#pragma unroll
                        for (int j = 0; j < 4; ++j) { o[j] = tv[j] + gv[j] * acc[ai][bj][m][0][j]; o[4 + j] = tv[4 + j] + gv[4 + j] * acc[ai][bj][m][1][j]; }
                    }
                    *(u32x4*)pt = pack8(o);
                }
            }
    }
};

template <int MODE> struct EpiRes {
    const float* base; float* out; bf16_t* hb; float* part;
    __device__ __forceinline__ void operator()(const AccT& acc, const Unit& u, int wr, int wc, int fr, int fq) const {
        const int row0 = u.pm * 256 + wr * 64 + fr, col0 = u.pn * 256 + 32 * wc + 8 * fq;
#pragma unroll
        for (int ai = 0; ai < 2; ++ai)
#pragma unroll
            for (int m = 0; m < 4; ++m) {
                const int row = row0 + ai * 128 + m * 16;
                float ss = 0.f;
#pragma unroll
                for (int bj = 0; bj < 2; ++bj) {
                    const size_t off = (size_t)row * DM + col0 + bj * 128;
                    const f32x4 b0 = *(const f32x4*)(base + off), b1 = *(const f32x4*)(base + off + 4);
                    const f32x4 o0 = b0 + acc[ai][bj][m][0], o1 = b1 + acc[ai][bj][m][1];
                    *(f32x4*)(out + off) = o0; *(f32x4*)(out + off + 4) = o1;
                    ss += o0[0] * o0[0] + o0[1] * o0[1] + o0[2] * o0[2] + o0[3] * o0[3] + o1[0] * o1[0] + o1[1] * o1[1] + o1[2] * o1[2] + o1[3] * o1[3];
                    if (MODE == 0) { u32x4 w; w.x = cvt_pk_bf16(o0[0], o0[1]); w.y = cvt_pk_bf16(o0[2], o0[3]); w.z = cvt_pk_bf16(o1[0], o1[1]); w.w = cvt_pk_bf16(o1[2], o1[3]); *(u32x4*)(hb + off) = w; }
                }
                ss += __shfl_xor(ss, 16); ss += __shfl_xor(ss, 32);
                if (fq == 0) part[(size_t)row * 16 + u.pn * 4 + wc] = ss;
            }
    }
};

struct EpiFfnIn {
    bf16_t* hid; const float* part;
    __device__ __forceinline__ void operator()(const AccT& acc, const Unit& u, int wr, int wc, int fr, int fq) const {
        const int row0 = u.pm * 256 + wr * 64 + fr, col0 = u.pn * 128 + 32 * wc + 8 * fq;
#pragma unroll
        for (int ai = 0; ai < 2; ++ai)
#pragma unroll
            for (int m = 0; m < 4; ++m) {
                const int row = row0 + ai * 128 + m * 16;
                const f32x4 p0 = *(const f32x4*)(part + (size_t)row * 16), p1 = *(const f32x4*)(part + (size_t)row * 16 + 4), p2 = *(const f32x4*)(part + (size_t)row * 16 + 8), p3 = *(const f32x4*)(part + (size_t)row * 16 + 12);
                const f32x4 ps = (p0 + p1) + (p2 + p3);
                const float rstd = rsqrtf(((ps[0] + ps[1]) + (ps[2] + ps[3])) * (1.0f / DM) + NORM_EPS);
                float o[8];
#pragma unroll
                for (int j = 0; j < 4; ++j) { o[j] = siluf_(rstd * acc[ai][0][m][0][j]) * (rstd * acc[ai][1][m][0][j]); o[4 + j] = siluf_(rstd * acc[ai][0][m][1][j]) * (rstd * acc[ai][1][m][1][j]); }
                *(u32x4*)(hid + (size_t)row * FH + col0) = pack8(o);
            }
    }
};

__device__ __forceinline__ unsigned off_b(unsigned row, unsigned ch) { return 256u * row + 16u * (ch ^ (((row & 3) << 2) | ((row >> 2) & 3))); }
__device__ __forceinline__ unsigned row_read_addr_16(unsigned lane, unsigned rb, unsigned s) { return off_b((lane & 15) + 16 * rb, 4 * s + (lane >> 4)); }
__device__ __forceinline__ unsigned tr_read_addr_16(unsigned lane, unsigned c, unsigned ks, unsigned t) {
    const unsigned g = lane >> 4, q = (lane & 15) >> 2, p = lane & 3;
    return off_b(32 * ks + 8 * g + 4 * t + q, 2 * c + (p >> 1)) + 8 * (p & 1);
}
__device__ __forceinline__ bf16x8 tr_frag(LAS unsigned char* img, unsigned lane, unsigned c, unsigned ks) {
    const s16x4 lo = __builtin_amdgcn_ds_read_tr16_b64_v4i16((LAS s16x4*)(img + tr_read_addr_16(lane, c, ks, 0)));
    const s16x4 hi = __builtin_amdgcn_ds_read_tr16_b64_v4i16((LAS s16x4*)(img + tr_read_addr_16(lane, c, ks, 1)));
    return (bf16x8){lo[0], lo[1], lo[2], lo[3], hi[0], hi[1], hi[2], hi[3]};
}
__device__ __forceinline__ bf16x8 row_frag(LAS unsigned char* img, unsigned lane, unsigned rb, unsigned s) { return *(const LAS bf16x8*)(img + row_read_addr_16(lane, rb, s)); }

__device__ __forceinline__ int wsrc_col(int w, int r, int& sel) {
    sel = 0;
    const int p32 = (r & ~31) + pg8::perm32(r & 31);
    if (w == 0) { if (r < 2048) { const int p = r & 127; const int wc = p >> 5, n = (p >> 4) & 1, fq = (p >> 2) & 3, j = p & 3; return (r & ~127) + 64 * n + 16 * wc + 4 * fq + j; } return p32; }
    if (w == 1) { const int pn = r >> 8, half = (r >> 7) & 1, p = r & 127; sel = (pn >> 1) * 2 + half; return 128 * (pn & 1) + (p & ~31) + pg8::perm32(p & 31); }
    if (w == 5) { const int pn = r >> 8, half = (r >> 7) & 1, p = r & 127; return half * FH + 128 * pn + (p & ~31) + pg8::perm32(p & 31); }
    return p32;
}

__device__ void phase0(const Params& p, LAS unsigned char* lds) {
    const int tid = threadIdx.x, lane = tid & 63, wave = tid >> 6, G = gridDim.x, bid = blockIdx.x;
    unsigned char* ws = p.ws;
    LAS float* T = (LAS float*)lds;
    for (int idx = bid; idx < 5056; idx += G) {
        int w, i = idx, Kd, ktn; const float* src; int ldw; bf16_t* dst; const float* scale = nullptr;
        if (i < 2048) { w = 0; Kd = 1024; ktn = 16; src = p.in[3]; ldw = INC; dst = (bf16_t*)(ws + WS_W1T); }
        else if ((i -= 2048) < 128) { w = 1; Kd = 256; ktn = 4; src = nullptr; ldw = 256; dst = (bf16_t*)(ws + WS_WGT); }
        else if ((i -= 128) < 256) { w = 2; Kd = 1024; ktn = 16; src = p.in[11]; ldw = 1024; dst = (bf16_t*)(ws + WS_WBR); }
        else if ((i -= 256) < 256) { w = 3; Kd = 1024; ktn = 16; src = p.in[12]; ldw = 1024; dst = (bf16_t*)(ws + WS_WBL); }
        else if ((i -= 256) < 256) { w = 4; Kd = 1024; ktn = 16; src = p.in[13]; ldw = 1024; dst = (bf16_t*)(ws + WS_WOUT); }
        else if ((i -= 256) < 1408) { w = 5; Kd = 1024; ktn = 16; src = p.in[15]; ldw = 2 * FH; dst = (bf16_t*)(ws + WS_WFI); scale = p.in[14]; }
        else { i -= 1408; w = 6; Kd = FH; ktn = 44; src = p.in[16]; ldw = 1024; dst = (bf16_t*)(ws + WS_WFO); }
        const int rt = i / ktn, kt = i % ktn;
        {
            const int tx = tid & 63, ty = tid >> 6; int sel; const int r = rt * 64 + tx; const int col = wsrc_col(w, r, sel);
            const float* s = src;
            if (w == 1) s = ((sel & 1) ? p.in[8] : p.in[6]) + (size_t)(sel >> 1) * 65536;
#pragma unroll
            for (int q = 0; q < 8; ++q) { const int k = kt * 64 + ty + 8 * q; float v = s[(size_t)k * ldw + col]; if (scale) v *= scale[k]; T[(ty + 8 * q) * 65 + tx] = v; }
        }
        __syncthreads();
        {
            const int n = tid >> 3, kq = tid & 7; float v[8];
#pragma unroll
            for (int j = 0; j < 8; ++j) v[j] = T[(kq * 8 + j) * 65 + n];
            *(u32x4*)(dst + (size_t)(rt * 64 + n) * Kd + kt * 64 + kq * 8) = pack8(v);
        }
        __syncthreads();
    }
    if (bid == G - 1) { for (int c = tid; c < DM; c += 512) ((float*)(ws + WS_SPT))[c] = -8.0f * log1pf(expf(-p.in[10][c])); }
    {
        float* cosT = (float*)(ws + WS_COS); float* sinT = (float*)(ws + WS_SIN);
        for (int idx = bid * 512 + tid; idx < (SEQ + NMETA) * 64; idx += G * 512) {
            const int pos = idx >> 6, i = idx & 63;
            const float invf = (float)pow(10000.0, -(double)i / 64.0);
            const float ang = (float)pos * invf;
            const double rev = (double)ang * 0.15915494309189535; const float fr = (float)(rev - rint(rev));
            cosT[idx] = __builtin_amdgcn_cosf(fr); sinT[idx] = __builtin_amdgcn_sinf(fr);
        }
    }
    {
        const float* x = p.in[0]; const float* nw = p.in[2]; bf16_t* U = (bf16_t*)p.out;
        f32x4 wv[4];
#pragma unroll
        for (int i = 0; i < 4; ++i) wv[i] = *(const f32x4*)(nw + lane * 4 + 256 * i);
        for (int row = bid * 8 + wave; row < NROW; row += G * 8) {
            f32x4 v[4]; float ss = 0.f;
#pragma unroll
            for (int i = 0; i < 4; ++i) { v[i] = *(const f32x4*)(x + (size_t)row * DM + lane * 4 + 256 * i); ss += v[i][0] * v[i][0] + v[i][1] * v[i][1] + v[i][2] * v[i][2] + v[i][3] * v[i][3]; }
#pragma unroll
            for (int o = 32; o >= 1; o >>= 1) ss += __shfl_xor(ss, o);
            const float rstd = rsqrtf(ss * (1.0f / DM) + NORM_EPS);
#pragma unroll
            for (int i = 0; i < 4; ++i) { const f32x4 o = v[i] * rstd * wv[i]; u32x2 w; w.x = cvt_pk_bf16(o[0], o[1]); w.y = cvt_pk_bf16(o[2], o[3]); *(u32x2*)(U + (size_t)row * DM + lane * 4 + 256 * i) = w; }
        }
    }
    __syncthreads();
    for (int blk = bid; blk < 96; blk += G) {
        LAS float* um = (LAS float*)lds; LAS float* red = um + 1024;
        const int j = blk / 6; const float* mt = p.in[1] + j * DM;
        const float a = mt[tid], b = mt[tid + 512];
        float ss = a * a + b * b;
#pragma unroll
        for (int o = 32; o >= 1; o >>= 1) ss += __shfl_xor(ss, o);
        if (lane == 0) red[wave] = ss;
        __syncthreads();
        float tot = 0.f;
#pragma unroll
        for (int q = 0; q < 8; ++q) tot += red[q];
        const float rstd = rsqrtf(tot * (1.0f / DM) + NORM_EPS);
        um[tid] = a * rstd * p.in[2][tid]; um[tid + 512] = b * rstd * p.in[2][tid + 512];
        __syncthreads();
        const int cidx = (blk % 6) * 512 + tid;
        const int col = cidx < 1024 ? 1024 + cidx : (cidx < 2048 ? 2048 + (cidx - 1024) : 4096 + (cidx - 2048));
        const float* wp = p.in[3] + col; float accv = 0.f;
#pragma unroll 8
        for (int k = 0; k < DM; ++k) accv += um[k] * wp[(size_t)k * INC];
        ((float*)(ws + WS_KVLM))[j * 3072 + cidx] = accv;
        __syncthreads();
    }
}

__device__ void phase_conv(const Params& p, LAS unsigned char* lds) {
    const int tid = threadIdx.x, G = gridDim.x, bid = blockIdx.x;
    unsigned char* ws = p.ws;
    const bf16_t* LIN = (const bf16_t*)(ws + WS_LIN); bf16_t* C = (bf16_t*)p.out; const float* kvlm = (const float*)(ws + WS_KVLM);
    const float* cw = p.in[4]; const float* cb = p.in[5];
    for (int blk = bid; blk < 256; blk += G) {
        const int cc = tid & 127, tq = tid >> 7, ch0 = cc * 8, t0 = blk * 256 + tq * 64;
        float w[4][8], bb[8], h1[8], h2[8], h3[8];
#pragma unroll
        for (int q = 0; q < 4; ++q) { const f32x4 a = *(const f32x4*)(cw + q * DM + ch0), b = *(const f32x4*)(cw + q * DM + ch0 + 4);
#pragma unroll
            for (int j = 0; j < 4; ++j) { w[q][j] = a[j]; w[q][4 + j] = b[j]; } }
        { const f32x4 a = *(const f32x4*)(cb + ch0), b = *(const f32x4*)(cb + ch0 + 4);
#pragma unroll
            for (int j = 0; j < 4; ++j) { bb[j] = a[j]; bb[4 + j] = b[j]; } }
        if ((t0 & (SEQ - 1)) == 0) {
#pragma unroll
            for (int j = 0; j < 8; ++j) { h1[j] = kvlm[15 * 3072 + 2048 + ch0 + j]; h2[j] = kvlm[14 * 3072 + 2048 + ch0 + j]; h3[j] = kvlm[13 * 3072 + 2048 + ch0 + j]; }
        } else {
            unpack8(*(const u32x4*)(LIN + (size_t)(t0 - 1) * DM + ch0), h1); unpack8(*(const u32x4*)(LIN + (size_t)(t0 - 2) * DM + ch0), h2); unpack8(*(const u32x4*)(LIN + (size_t)(t0 - 3) * DM + ch0), h3);
        }
#pragma unroll 4
        for (int t = 0; t < 64; ++t) {
            float cur[8], o[8]; unpack8(*(const u32x4*)(LIN + (size_t)(t0 + t) * DM + ch0), cur);
#pragma unroll
            for (int j = 0; j < 8; ++j) { o[j] = bb[j] + w[0][j] * h3[j] + w[1][j] * h2[j] + w[2][j] * h1[j] + w[3][j] * cur[j]; h3[j] = h2[j]; h2[j] = h1[j]; h1[j] = cur[j]; }
            *(u32x4*)(C + (size_t)(t0 + t) * DM + ch0) = pack8(o);
        }
    }
    __syncthreads();
    for (int blk = bid; blk < 32; blk += G) {
        LAS float* cm = (LAS float*)lds;
        const int j = blk >> 1, chb = (blk & 1) * 512, ch = chb + tid;
        float cv = cb[ch];
#pragma unroll
        for (int q = 0; q < 4; ++q) { const int jj = j - 3 + q; if (jj >= 0) cv += cw[q * DM + ch] * kvlm[jj * 3072 + 2048 + ch]; }
        cm[tid] = cv;
        __syncthreads();
        const int g = ch >> 8, jc = ch & 255; const float* wa = p.in[6] + (size_t)g * 65536 + jc; const float* wx = p.in[8] + (size_t)g * 65536 + jc;
        LAS float* cmg = cm + ((tid >> 8) << 8);
        float ra = 0.f, ia = 0.f;
#pragma unroll 8
        for (int i = 0; i < 256; ++i) { const float c = cmg[i]; ra += c * wa[i * 256]; ia += c * wx[i * 256]; }
        const float r = 1.0f / (1.0f + expf(-(ra + p.in[7][ch]))), ig = 1.0f / (1.0f + expf(-(ia + p.in[9][ch])));
        const float la = -8.0f * r * log1pf(expf(-p.in[10][ch]));
        float* aum = (float*)(ws + WS_AUM);
        aum[j * DM + ch] = expf(la); aum[16 * DM + j * DM + ch] = sqrtf(-expm1f(2.0f * la)) * ig * cv;
        __syncthreads();
    }
}

__device__ void phase_r1(const Params& p, LAS unsigned char* lds) {
    const int tid = threadIdx.x, lane = tid & 63, wave = tid >> 6, G = gridDim.x, bid = blockIdx.x;
    unsigned char* ws = p.ws;
    const bf16_t* Kg = (const bf16_t*)(ws + WS_K); const bf16_t* Vg = (const bf16_t*)(ws + WS_V); bf16_t* KV = (bf16_t*)(ws + WS_KVST);
    LAS unsigned char* Ki = lds; LAS unsigned char* Vi = lds + 32768;
    for (int it = bid; it < 4096; it += G) {
        const int h = it & 7, c = (it >> 3) & 63, b = it >> 9; const size_t tok0 = (size_t)b * SEQ + c * 128;
        const float l2g = head_log2g(h);
        unsigned ln = lane; asm volatile("" : "+v"(ln));
#pragma unroll
        for (int i = 0; i < 4; ++i) {
            const int n = tid + 512 * i, row = n >> 4, ch = n & 15;
            const u32x4 kw = *(const u32x4*)(Kg + (tok0 + row) * DM + h * 128 + ch * 8), vw = *(const u32x4*)(Vg + (tok0 + row) * DM + h * 128 + ch * 8);
            float kf[8]; unpack8(kw, kf); const float kd = exp2f((float)(127 - row) * l2g);
#pragma unroll
            for (int j = 0; j < 8; ++j) kf[j] *= kd;
            *(LAS u32x4*)(Ki + off_b(row, ch)) = pack8(kf); *(LAS u32x4*)(Vi + off_b(row, ch)) = vw;
        }
        __syncthreads();
        f32x4 acc[8];
#pragma unroll
        for (int nt = 0; nt < 8; ++nt) acc[nt] = (f32x4){0.f, 0.f, 0.f, 0.f};
#pragma unroll
        for (int ks = 0; ks < 4; ++ks) {
            const bf16x8 a = tr_frag(Vi, ln, wave, ks);
#pragma unroll
            for (int nt = 0; nt < 8; ++nt) { const bf16x8 bb = tr_frag(Ki, ln, nt, ks); acc[nt] = __builtin_amdgcn_mfma_f32_16x16x32_bf16(a, bb, acc[nt], 0, 0, 0); }
        }
        bf16_t* dst = KV + ((size_t)((b * 8 + h) * 64 + c)) * 16384;
#pragma unroll
        for (int nt = 0; nt < 8; ++nt)
#pragma unroll
            for (int jj = 0; jj < 4; ++jj) { const int dv = 16 * wave + 4 * (lane >> 4) + jj, dk = 16 * nt + (lane & 15); dst[dv * 128 + dk] = (bf16_t)(cvt_pk_bf16(acc[nt][jj], 0.f) & 0xffffu); }
        __syncthreads();
    }
}

__device__ void phase_prefix(const Params& p) {
    const int tid = threadIdx.x, G = gridDim.x, bid = blockIdx.x;
    unsigned char* ws = p.ws;
    bf16_t* KV = (bf16_t*)(ws + WS_KVST); const float* kvlm = (const float*)(ws + WS_KVLM); const float* cosT = (const float*)(ws + WS_COS); const float* sinT = (const float*)(ws + WS_SIN);
    for (int gid = bid * 512 + tid; gid < 131072; gid += G * 512) {
        const int bh = gid >> 11, e8 = gid & 2047, h = bh & 7, dv = e8 >> 4, dk0 = (e8 & 15) * 8;
        const float l2g = head_log2g(h), g128 = exp2f(128.0f * l2g);
        float st[8];
#pragma unroll
        for (int e = 0; e < 8; ++e) st[e] = 0.f;
        for (int j = 0; j < NMETA; ++j) {
            const float vj = kvlm[j * 3072 + 1024 + h * 128 + dv] * exp2f((float)(15 - j) * l2g) * 0.08838834764831845f;
#pragma unroll
            for (int e = 0; e < 8; ++e) {
                const int dk = dk0 + e, i = dk & 63; const float cs = cosT[j * 64 + i], sn = sinT[j * 64 + i];
                const float x1 = kvlm[j * 3072 + h * 128 + i], x2 = kvlm[j * 3072 + h * 128 + 64 + i];
                const float kr = dk < 64 ? x1 * cs - x2 * sn : x2 * cs + x1 * sn;
                st[e] += vj * kr;
            }
        }
        bf16_t* ptr = KV + (size_t)bh * 64 * 16384 + e8 * 8;
#pragma unroll 4
        for (int c = 0; c < 64; ++c) {
            float kv[8]; unpack8(*(const u32x4*)(ptr + (size_t)c * 16384), kv);
            *(u32x4*)(ptr + (size_t)c * 16384) = pack8(st);
#pragma unroll
            for (int e = 0; e < 8; ++e) st[e] = st[e] * g128 + kv[e];
        }
    }
    const float* aggA = (const float*)(ws + WS_AGGA); const float* aggH = (const float*)(ws + WS_AGGH); float* hin = (float*)(ws + WS_HIN); const float* hmeta = (const float*)(ws + WS_HMETA);
    for (int gid = bid * 512 + tid; gid < NBATCH * DM; gid += G * 512) {
        const int b = gid >> 10, ch = gid & 1023; float h = hmeta[ch];
#pragma unroll 8
        for (int s = 0; s < 128; ++s) { const size_t o = (size_t)(b * 128 + s) * DM + ch; hin[o] = h; h = aggA[o] * h + aggH[o]; }
    }
}

__device__ void phase_r3(const Params& p, LAS unsigned char* lds) {
    const int tid = threadIdx.x, lane = tid & 63, wave = tid >> 6, G = gridDim.x, bid = blockIdx.x;
    unsigned char* ws = p.ws;
    bf16_t* Qg = (bf16_t*)(ws + WS_Q); const bf16_t* Kg = (const bf16_t*)(ws + WS_K); const bf16_t* Vg = (const bf16_t*)(ws + WS_V); const bf16_t* Gg = (const bf16_t*)(ws + WS_G);
    const bf16_t* KV = (const bf16_t*)(ws + WS_KVST);
    LAS unsigned char* Qi = lds; LAS unsigned char* Ki = lds + 32768; LAS unsigned char* Vi = lds + 65536; LAS unsigned char* Si = lds + 98304;
    for (int it = bid; it < 4096; it += G) {
        const int h = it & 7, c = (it >> 3) & 63, b = it >> 9; const size_t tok0 = (size_t)b * SEQ + c * 128;
        const float l2g = head_log2g(h);
        unsigned ln = lane; asm volatile("" : "+v"(ln));
        const bf16_t* stp = KV + ((size_t)((b * 8 + h) * 64 + c)) * 16384;
#pragma unroll
        for (int i = 0; i < 4; ++i) {
            const int n = tid + 512 * i, row = n >> 4, ch = n & 15; const size_t go = (tok0 + row) * DM + h * 128 + ch * 8; const unsigned lo = off_b(row, ch);
            *(LAS u32x4*)(Qi + lo) = *(const u32x4*)(Qg + go); *(LAS u32x4*)(Ki + lo) = *(const u32x4*)(Kg + go); *(LAS u32x4*)(Vi + lo) = *(const u32x4*)(Vg + go);
            *(LAS u32x4*)(Si + lo) = *(const u32x4*)(stp + n * 8);
        }
        __syncthreads();
        bf16x8 qf[4];
#pragma unroll
        for (int ks = 0; ks < 4; ++ks) qf[ks] = row_frag(Qi, ln, wave, ks);
        f32x4 sacc[8];
#pragma unroll
        for (int nt = 0; nt < 8; ++nt) {
            sacc[nt] = (f32x4){0.f, 0.f, 0.f, 0.f};
#pragma unroll
            for (int ks = 0; ks < 4; ++ks) sacc[nt] = __builtin_amdgcn_mfma_f32_16x16x32_bf16(qf[ks], row_frag(Ki, ln, nt, ks), sacc[nt], 0, 0, 0);
        }
        __syncthreads();
        asm volatile("" : "+v"(ln));
#pragma unroll
        for (int nt = 0; nt < 8; ++nt)
#pragma unroll
            for (int jj = 0; jj < 4; ++jj) {
                const int i = 16 * wave + 4 * (ln >> 4) + jj, j = 16 * nt + (ln & 15);
                const float v = i >= j ? sacc[nt][jj] * exp2f((float)(i - j) * l2g) : 0.f;
                *(LAS bf16_t*)(Ki + off_b(i, j >> 3) + (j & 7) * 2) = (bf16_t)(cvt_pk_bf16(v, 0.f) & 0xffffu);
            }
        __syncthreads();
        asm volatile("" : "+v"(ln));
        f32x4 oacc[8];
#pragma unroll
        for (int nt = 0; nt < 8; ++nt) {
            oacc[nt] = (f32x4){0.f, 0.f, 0.f, 0.f};
#pragma unroll
            for (int ks = 0; ks < 4; ++ks) oacc[nt] = __builtin_amdgcn_mfma_f32_16x16x32_bf16(qf[ks], row_frag(Si, ln, nt, ks), oacc[nt], 0, 0, 0);
        }
        float qd[4];
#pragma unroll
        for (int jj = 0; jj < 4; ++jj) qd[jj] = exp2f((float)(16 * wave + 4 * (lane >> 4) + jj + 1) * l2g);
#pragma unroll
        for (int nt = 0; nt < 8; ++nt)
#pragma unroll
            for (int jj = 0; jj < 4; ++jj) oacc[nt][jj] *= qd[jj];
#pragma unroll
        for (int ks = 0; ks < 4; ++ks) {
            const bf16x8 pf = row_frag(Ki, ln, wave, ks);
#pragma unroll
            for (int nt = 0; nt < 8; ++nt) oacc[nt] = __builtin_amdgcn_mfma_f32_16x16x32_bf16(pf, tr_frag(Vi, ln, nt, ks), oacc[nt], 0, 0, 0);
        }
        float rs[4];
#pragma unroll
        for (int jj = 0; jj < 4; ++jj) {
            float ss = 0.f;
#pragma unroll
            for (int nt = 0; nt < 8; ++nt) ss += oacc[nt][jj] * oacc[nt][jj];
            ss += __shfl_xor(ss, 1); ss += __shfl_xor(ss, 2); ss += __shfl_xor(ss, 4); ss += __shfl_xor(ss, 8);
            rs[jj] = rsqrtf(ss * (1.0f / 128.0f) + NORM_EPS);
        }
        __syncthreads();
        LAS float* Of = (LAS float*)lds;
        asm volatile("" : "+v"(ln));
#pragma unroll
        for (int nt = 0; nt < 8; ++nt)
#pragma unroll
            for (int jj = 0; jj < 4; ++jj) { const int i = 16 * wave + 4 * (ln >> 4) + jj, dv = 16 * nt + (ln & 15); Of[i * 128 + ((dv + 4 * i) & 127)] = oacc[nt][jj] * rs[jj]; }
        __syncthreads();
#pragma unroll
        for (int i = 0; i < 4; ++i) {
            const int n = tid + 512 * i, row = n >> 4, ch = n & 15; const size_t go = (tok0 + row) * DM + h * 128 + ch * 8;
            float gv[8]; unpack8(*(const u32x4*)(Gg + go), gv);
#pragma unroll
            for (int j = 0; j < 8; ++j) gv[j] *= Of[row * 128 + ((ch * 8 + j + 4 * row) & 127)];
            *(u32x4*)(Qg + go) = pack8(gv);
        }
        __syncthreads();
    }
}

__device__ void phase_final(const Params& p) {
    const int tid = threadIdx.x, lane = tid & 63, wave = tid >> 6, G = gridDim.x, bid = blockIdx.x;
    const float* part = (const float*)(p.ws + WS_PART2); const float* nw = p.in[17]; float* out = p.out;
    f32x4 wv[4];
#pragma unroll
    for (int i = 0; i < 4; ++i) wv[i] = *(const f32x4*)(nw + lane * 4 + 256 * i);
    for (int row = bid * 8 + wave; row < NROW; row += G * 8) {
        float ps = lane < 16 ? part[(size_t)row * 16 + lane] : 0.f;
        ps += __shfl_xor(ps, 1); ps += __shfl_xor(ps, 2); ps += __shfl_xor(ps, 4); ps += __shfl_xor(ps, 8);
        const float tot = __shfl(ps, 0);
        const float rstd = rsqrtf(tot * (1.0f / DM) + NORM_EPS);
#pragma unroll
        for (int i = 0; i < 4; ++i) { float* q = out + (size_t)row * DM + lane * 4 + 256 * i; *(f32x4*)q = *(const f32x4*)q * rstd * wv[i]; }
    }
}

constexpr int NPHASE = 11;
__global__ void __launch_bounds__(512) mk(Params p) {
    extern __shared__ __attribute__((aligned(16))) unsigned char smem[];
    LAS unsigned char* lds = (LAS unsigned char*)smem;
    unsigned char* ws = p.ws;
    const int lo = p.ph_lo, G = gridDim.x, bid = blockIdx.x;
#ifdef DBG_STOP
    const int hi = DBG_STOP + 1;
#else
    const int hi = p.ph_hi;
#endif
#ifndef PH_MASK
#define PH_MASK 0x7ff
#endif
#define IN(k) (((PH_MASK >> (k)) & 1) && lo <= (k) && (k) < hi)
#define SEAM(k) do { if ((k) + 1 < hi) { cg::this_grid().sync(); } } while (0)
    if (IN(0)) { phase0(p, lds); SEAM(0); }
    if (IN(1)) {
        pg8::Gemm g{(const bf16_t*)p.out, (const bf16_t*)(ws + WS_W1T), NROW, INC, DM, DM, 0}; pg8::StaticOrder S; S.init(NROW, INC, G, bid);
        Epi1 E{ws, (unsigned char*)p.out, (const float*)(ws + WS_COS), (const float*)(ws + WS_SIN)};
        pg8::gemm_phase<Epi1, false>(lds, g, S, E);
        SEAM(1);
    }
    if (IN(2)) { phase_conv(p, lds); SEAM(2); }
    if (IN(3)) {
        {
            const int ch = bid * 512 + threadIdx.x;
            if (ch < DM) { const float* aum = (const float*)(ws + WS_AUM); float h = 0.f; for (int j = 0; j < NMETA; ++j) h = aum[j * DM + ch] * h + aum[16 * DM + j * DM + ch]; ((float*)(ws + WS_HMETA))[ch] = h; }
        }
#ifndef NO_R
        phase_r1(p, lds);
#endif
        pg8::Gemm g{(const bf16_t*)p.out, (const bf16_t*)(ws + WS_WGT), NROW, 2048, 256, DM, 1}; pg8::StaticOrder S; S.init(NROW, 2048, G, bid);
        EpiGate<1> E{ws, (const bf16_t*)p.out, p.in[7], p.in[9]};
        pg8::gemm_phase<EpiGate<1>, true>(lds, g, S, E);
        SEAM(3);
    }
    if (IN(4)) { phase_prefix(p); SEAM(4); }
    if (IN(5)) {
#ifndef NO_R
        phase_r3(p, lds);
#endif
        pg8::Gemm g{(const bf16_t*)p.out, (const bf16_t*)(ws + WS_WGT), NROW, 2048, 256, DM, 1}; pg8::StaticOrder S; S.init(NROW, 2048, G, bid);
        EpiGate<3> E{ws, (const bf16_t*)p.out, p.in[7], p.in[9]};
        pg8::gemm_phase<EpiGate<3>, true>(lds, g, S, E);
        SEAM(5);
    }
    if (IN(6)) {
        pg8::StaticOrder S; S.init(NROW, DM, G, bid);
        { pg8::Gemm g{(const bf16_t*)(ws + WS_Q), (const bf16_t*)(ws + WS_WBR), NROW, DM, DM, DM, 0}; EpiBr<0> E{(bf16_t*)(ws + WS_GA), nullptr}; pg8::gemm_phase<EpiBr<0>, false>(lds, g, S, E); }
        { pg8::Gemm g{(const bf16_t*)(ws + WS_LG), (const bf16_t*)(ws + WS_WBL), NROW, DM, DM, DM, 0}; EpiBr<1> E{(bf16_t*)(ws + WS_GA), (const bf16_t*)((unsigned char*)p.out + 128 * MiB)}; pg8::gemm_phase<EpiBr<1>, false>(lds, g, S, E); }
        SEAM(6);
    }
    if (IN(7)) {
        pg8::StaticOrder S; S.init(NROW, DM, G, bid);
        pg8::Gemm g{(const bf16_t*)(ws + WS_GA), (const bf16_t*)(ws + WS_WOUT), NROW, DM, DM, DM, 0};
        EpiRes<0> E{p.in[0], p.out, (bf16_t*)(ws + WS_H2B), (float*)(ws + WS_PART1)};
        pg8::gemm_phase<EpiRes<0>, false>(lds, g, S, E);
        SEAM(7);
    }
    if (IN(8)) {
        pg8::StaticOrder S; S.init(NROW, 2 * FH, G, bid);
        pg8::Gemm g{(const bf16_t*)(ws + WS_H2B), (const bf16_t*)(ws + WS_WFI), NROW, 2 * FH, DM, DM, 0};
        EpiFfnIn E{(bf16_t*)(ws + WS_HID), (const float*)(ws + WS_PART1)};
        pg8::gemm_phase<EpiFfnIn, false>(lds, g, S, E);
        SEAM(8);
    }
    if (IN(9)) {
        pg8::StaticOrder S; S.init(NROW, DM, G, bid);
        pg8::Gemm g{(const bf16_t*)(ws + WS_HID), (const bf16_t*)(ws + WS_WFO), NROW, DM, FH, FH, 0};
        EpiRes<1> E{p.out, p.out, nullptr, (float*)(ws + WS_PART2)};
        pg8::gemm_phase<EpiRes<1>, false>(lds, g, S, E);
        SEAM(9);
    }
    if (IN(10)) { phase_final(p); }
#ifdef DBG_STOP
    {
        cg::this_grid().sync();
        const unsigned char* regs[12]; size_t lens[12]; int nr = 0;
        unsigned char* ob = (unsigned char*)p.out;
#define REG(ptr, len) do { regs[nr] = (const unsigned char*)(ptr); lens[nr] = (size_t)(len); ++nr; } while (0)
        if (DBG_STOP == 0) { REG(ws + WS_MISC, 40 * MiB); REG(ws + WS_COS, 2101248); REG(ws + WS_SIN, 2101248); REG(ws + WS_KVLM, 196608); REG(ws + WS_SPT, 4096); REG(ob, 128 * MiB); }
        if (DBG_STOP == 1) { REG(ws + WS_Q, 128 * MiB); REG(ws + WS_K, 128 * MiB); REG(ws + WS_V, 128 * MiB); REG(ws + WS_G, 128 * MiB); REG(ws + WS_LIN, 128 * MiB); REG(ws + WS_LG, 128 * MiB); REG(ws + WS_GA, 128 * MiB); REG(ob + 128 * MiB, 128 * MiB); }
        if (DBG_STOP == 2) { REG(ob, 128 * MiB); REG(ws + WS_AUM, 131072); }
#ifndef DBG_SUB
#define DBG_SUB 7
#endif
        if (DBG_STOP == 3) { if (DBG_SUB & 1) REG(ws + WS_KVST, 128 * MiB); if (DBG_SUB & 2) { REG(ws + WS_AGGA, 4 * MiB); REG(ws + WS_AGGH, 4 * MiB); } if (DBG_SUB & 4) REG(ws + WS_HMETA, 4096); }
        if (DBG_STOP == 4) { REG(ws + WS_KVST, 128 * MiB); REG(ws + WS_HIN, 4 * MiB); }
        if (DBG_STOP == 5) { REG(ws + WS_Q, 128 * MiB); REG(ws + WS_LG, 128 * MiB); }
        if (DBG_STOP == 6) { REG(ws + WS_GA, 128 * MiB); }
        if (DBG_STOP == 7) { REG(ob, 256 * MiB); REG(ws + WS_H2B, 128 * MiB); REG(ws + WS_PART1, 4 * MiB); }
        if (DBG_STOP == 8) { REG(ws + WS_HID, 352 * MiB); }
        if (DBG_STOP == 9) { REG(ob, 256 * MiB); REG(ws + WS_PART2, 4 * MiB); }
        float* scr = (float*)(ws + WS_MISC + 70 * MiB);
        for (int r = 0; r < nr; ++r) {
            const size_t nw = lens[r] / 4, per = (nw + G - 1) / G, w0 = per * bid, w1 = (w0 + per < nw) ? w0 + per : nw;
            unsigned s = 0; const unsigned* q = (const unsigned*)regs[r];
            for (size_t i = w0 + threadIdx.x; i < w1; i += 512) { const unsigned v = q[i]; s += v * 2654435761u + (v >> 15); }
            for (int o = 32; o >= 1; o >>= 1) s += __shfl_xor(s, o);
            if ((threadIdx.x & 63) == 0) scr[(r * 256 + bid) * 8 + (threadIdx.x >> 6)] = (float)(s & 0xFFFFFu);
        }
        cg::this_grid().sync();
        for (size_t i = (size_t)bid * 512 + threadIdx.x; i < (size_t)NROW * DM; i += (size_t)G * 512) p.out[i] = i < (size_t)nr * 2048 ? scr[i] : 0.f;
    }
#endif
#undef IN
#undef SEAM
}

extern "C" void kernel_launch(void* const* d_in, const int* in_sizes, int n_in, void* d_out, int out_size, void* d_ws, size_t ws_size, hipStream_t stream) {
    static int grid = 0;
    if (grid == 0) {
        int dev = 0, cus = 0, per_cu = 0;
        hipGetDevice(&dev); hipDeviceGetAttribute(&cus, hipDeviceAttributeMultiprocessorCount, dev);
        hipFuncSetAttribute((const void*)mk, hipFuncAttributeMaxDynamicSharedMemorySize, LDS_BYTES);
        hipOccupancyMaxActiveBlocksPerMultiprocessor(&per_cu, (const void*)mk, 512, LDS_BYTES);
        if (per_cu < 1) per_cu = 1;
        grid = cus * per_cu; if (grid > 256) grid = 256; if (grid < 1) grid = 256;
        (void)hipGetLastError();
    }
    Params p{};
    for (int i = 0; i < 18; ++i) p.in[i] = (const float*)d_in[i];
    p.out = (float*)d_out; p.ws = (unsigned char*)d_ws;
#if MK_COOP
    p.ph_lo = 0; p.ph_hi = NPHASE;
    void* args[] = {&p};
    hipError_t e = hipLaunchCooperativeKernel((const void*)mk, dim3(grid), dim3(512), args, LDS_BYTES, stream);
    if (e != hipSuccess) fprintf(stderr, "cooperative launch failed: %s (grid %d)\n", hipGetErrorString(e), grid);
#else
    for (int ph = 0; ph < NPHASE; ++ph) { p.ph_lo = ph; p.ph_hi = ph + 1; hipLaunchKernelGGL(mk, dim3(grid), dim3(512), LDS_BYTES, stream, p); }
#endif
}
```
